# Optimizing an MI355X kernel written in HIP

```python
import math
import jax, jax.numpy as jnp
from jax import lax
import numpy as np

D_MODEL = 1024
BATCH = 8
SEQ = 2048
DEPTH = 4

CHUNK = 64
N_MIXERS = 3
A_HEADS = 16
A_HEAD_DIM = D_MODEL // A_HEADS
A_LEFT_CHUNKS = 8
A_BAND = (A_LEFT_CHUNKS + 1) * CHUNK
A_REL_CLIP = 128
B_HEADS = 4
B_KEY_DIM = D_MODEL // 2
B_VAL_DIM = D_MODEL
B_HK = B_KEY_DIM // B_HEADS
B_HV = B_VAL_DIM // B_HEADS
B_GATE_RANK = 16
B_GATE_TAU = 16.0
C_HEADS = 8
C_HEAD_DIM = D_MODEL // (2 * C_HEADS)
C_Q_BLOCK = 128
T5_BUCKETS = 32
T5_MAX_DIST = 128
FFN_HIDDEN = ((8 * D_MODEL + 3 * 256 - 1) // (3 * 256)) * 256
DN_ALPHA = (2.0 * DEPTH) ** 0.25
DN_BETA = (8.0 * DEPTH) ** -0.25
N_A = (DEPTH + 2) // 3
N_B = (DEPTH + 1) // 3
N_C = DEPTH // 3
LN_EPS = 1e-5
RMS_EPS = 1e-6

kernel_name = "hybrid_chunk_causal_deepnorm_trunk"


def layer_norm(x, g, b):
    xf = x.astype(jnp.float32)
    mu = jnp.mean(xf, axis=-1, keepdims=True)
    var = jnp.mean(jnp.square(xf - mu), axis=-1, keepdims=True)
    return ((xf - mu) * lax.rsqrt(var + LN_EPS) * g.astype(jnp.float32) + b.astype(jnp.float32)).astype(x.dtype)


def rms_norm(x, g):
    xf = x.astype(jnp.float32)
    ms = jnp.mean(jnp.square(xf), axis=-1, keepdims=True)
    return (xf * lax.rsqrt(ms + RMS_EPS) * g.astype(jnp.float32)).astype(x.dtype)


def t5_bucket(rel):
    nb = T5_BUCKETS // 2
    max_exact = nb // 2
    ret = (rel > 0).astype(jnp.int32) * nb
    n = jnp.abs(rel)
    is_small = n < max_exact
    n_f = jnp.maximum(n, 1).astype(jnp.float32)
    large = max_exact + (jnp.log(n_f / max_exact) / math.log(T5_MAX_DIST / max_exact) * (nb - max_exact)).astype(jnp.int32)
    large = jnp.minimum(large, nb - 1)
    return ret + jnp.where(is_small, n, large)


def chunk_band_attention(x, w_qkv, rel_bias, w_o):
    b, s, _ = x.shape
    nc = s // CHUNK
    q, k, v = jnp.split(x @ w_qkv, 3, axis=-1)
    q = q.reshape(b, s, A_HEADS, A_HEAD_DIM) * (A_HEAD_DIM ** -0.5)
    k = k.reshape(b, s, A_HEADS, A_HEAD_DIM)
    v = v.reshape(b, s, A_HEADS, A_HEAD_DIM)
    pad = A_LEFT_CHUNKS * CHUNK
    kp = jnp.pad(k, ((0, 0), (pad, 0), (0, 0), (0, 0)))
    vp = jnp.pad(v, ((0, 0), (pad, 0), (0, 0), (0, 0)))
    q_off = jnp.arange(CHUNK)
    k_off = jnp.arange(A_BAND)
    rel = (q_off[:, None] + pad) - k_off[None, :]
    bias = rel_bias[jnp.clip(rel, -A_REL_CLIP, A_REL_CLIP) + A_REL_CLIP]
    bias = jnp.transpose(bias, (2, 0, 1)).astype(jnp.float32)

    def one_chunk(c):
        start = c * CHUNK
        qc = lax.dynamic_slice_in_dim(q, start, CHUNK, axis=1)
        kc = lax.dynamic_slice_in_dim(kp, start, A_BAND, axis=1)
        vc = lax.dynamic_slice_in_dim(vp, start, A_BAND, axis=1)
        logits = jnp.einsum('bqhd,bkhd->bhqk', qc, kc).astype(jnp.float32) + bias[None]
        valid = (start - pad + k_off) >= 0
        logits = jnp.where(valid[None, None, None, :], logits, -jnp.inf)
        p = jax.nn.softmax(logits, axis=-1).astype(vc.dtype)
        return jnp.einsum('bhqk,bkhd->bqhd', p, vc)

    out = lax.map(one_chunk, jnp.arange(nc))
    out = jnp.transpose(out, (1, 0, 2, 3, 4)).reshape(b, s, D_MODEL)
    return out @ w_o


def gated_linear_attention(x, w_in, w_g1, w_g2, b_g, g_norm, w_o):
    b, s, _ = x.shape
    nc = s // CHUNK
    q, k, v, r = jnp.split(x @ w_in, [B_KEY_DIM, 2 * B_KEY_DIM, 2 * B_KEY_DIM + B_VAL_DIM], axis=-1)
    log_a = jax.nn.log_sigmoid(((x @ w_g1) @ w_g2 + b_g).astype(jnp.float32)) / B_GATE_TAU
    q = q.reshape(b, nc, CHUNK, B_HEADS, B_HK) * (B_HK ** -0.5)
    k = k.reshape(b, nc, CHUNK, B_HEADS, B_HK)
    v = v.reshape(b, nc, CHUNK, B_HEADS, B_HV)
    log_a = log_a.reshape(b, nc, CHUNK, B_HEADS, B_HK)
    cum = jnp.cumsum(log_a, axis=2)
    total = cum[:, :, -1:]
    k_dec = k * jnp.exp(total - cum).astype(k.dtype)
    chunk_kv = jnp.einsum('bnchk,bnchv->bnhkv', k_dec, v)
    chunk_decay = jnp.exp(total[:, :, 0]).astype(chunk_kv.dtype)

    def step(state, inp):
        dec, kv = inp
        state = dec[..., None] * state + kv
        return state, state

    init = jnp.zeros((b, B_HEADS, B_HK, B_HV), chunk_kv.dtype)
    _, states = lax.scan(step, init, (jnp.moveaxis(chunk_decay, 1, 0), jnp.moveaxis(chunk_kv, 1, 0)))
    o = jnp.einsum('bnchk,nbhkv->bnchv', q, states)
    o = rms_norm(o, g_norm).reshape(b, s, B_VAL_DIM) * jax.nn.silu(r)
    return o @ w_o


def differential_attention(x, w_qkv, lam_q1, lam_k1, lam_q2, lam_k2, g_norm, w_o, t5_table, lambda_init):
    b, s, _ = x.shape
    q, k, v = jnp.split(x @ w_qkv, 3, axis=-1)
    q = q.reshape(b, s, C_HEADS, 2, C_HEAD_DIM) * (C_HEAD_DIM ** -0.5)
    k = k.reshape(b, s, C_HEADS, 2, C_HEAD_DIM)
    v = v.reshape(b, s, C_HEADS, 2 * C_HEAD_DIM)
    lam = (jnp.exp(jnp.sum(lam_q1.astype(jnp.float32) * lam_k1.astype(jnp.float32)))
           - jnp.exp(jnp.sum(lam_q2.astype(jnp.float32) * lam_k2.astype(jnp.float32))) + lambda_init)
    k_pos = jnp.arange(s)
    k_chunk = k_pos // CHUNK

    def one_block(blk):
        start = blk * C_Q_BLOCK
        qb = lax.dynamic_slice_in_dim(q, start, C_Q_BLOCK, axis=1)
        q_pos = start + jnp.arange(C_Q_BLOCK)
        logits = jnp.einsum('bqhmd,bkhmd->bhmqk', qb, k).astype(jnp.float32)
        bias = t5_table[t5_bucket(k_pos[None, :] - q_pos[:, None])]
        logits = logits + jnp.transpose(bias, (2, 0, 1)).astype(jnp.float32)[None, :, None]
        allowed = k_chunk[None, :] <= (q_pos // CHUNK)[:, None]
        logits = jnp.where(allowed[None, None, None], logits, -jnp.inf)
        p = jax.nn.softmax(logits, axis=-1)
        diff = (p[:, :, 0] - lam * p[:, :, 1]).astype(v.dtype)
        return jnp.einsum('bhqk,bkhe->bqhe', diff, v)

    out = lax.map(one_block, jnp.arange(s // C_Q_BLOCK))
    out = jnp.transpose(out, (1, 0, 2, 3, 4)).reshape(b, s, C_HEADS, 2 * C_HEAD_DIM)
    out = rms_norm(out, g_norm) * (1.0 - lambda_init)
    return out.reshape(b, s, D_MODEL) @ w_o


def swiglu(x, w_gate_up, w_down):
    g, u = jnp.split(x @ w_gate_up, 2, axis=-1)
    return (jax.nn.silu(g) * u) @ w_down


def setup_inputs(seed: int = 0) -> dict:
    key = jax.random.key(seed)
    ks = jax.random.split(key, 32)
    f32 = jnp.float32
    d = D_MODEL

    def nrm(k, shape, scale):
        return jax.random.normal(k, shape, f32) * scale

    return {
        "x": nrm(ks[0], (BATCH, SEQ, d), 1.0),
        "ln1_g": 1.0 + nrm(ks[1], (DEPTH, d), 0.02),
        "ln1_b": nrm(ks[2], (DEPTH, d), 0.02),
        "ln2_g": 1.0 + nrm(ks[3], (DEPTH, d), 0.02),
        "ln2_b": nrm(ks[4], (DEPTH, d), 0.02),
        "ffn_w_gate_up": nrm(ks[5], (DEPTH, d, 2 * FFN_HIDDEN), d ** -0.5),
        "ffn_w_down": nrm(ks[6], (DEPTH, FFN_HIDDEN, d), DN_BETA * FFN_HIDDEN ** -0.5),
        "t5_table": nrm(ks[7], (T5_BUCKETS, C_HEADS), 0.1),
        "a_w_qkv": nrm(ks[8], (N_A, d, 3 * d), d ** -0.5),
        "a_rel_bias": nrm(ks[9], (N_A, 2 * A_REL_CLIP + 1, A_HEADS), 0.1),
        "a_w_o": nrm(ks[10], (N_A, d, d), DN_BETA * d ** -0.5),
        "b_w_in": nrm(ks[11], (N_B, d, 2 * B_KEY_DIM + 2 * B_VAL_DIM), d ** -0.5),
        "b_w_g1": nrm(ks[12], (N_B, d, B_GATE_RANK), d ** -0.5),
        "b_w_g2": nrm(ks[13], (N_B, B_GATE_RANK, B_KEY_DIM), B_GATE_RANK ** -0.5),
        "b_b_g": nrm(ks[14], (N_B, B_KEY_DIM), 0.1),
        "b_g_norm": 1.0 + nrm(ks[15], (N_B, B_HV), 0.02),
        "b_w_o": nrm(ks[16], (N_B, B_VAL_DIM, d), DN_BETA * B_VAL_DIM ** -0.5),
        "c_w_qkv": nrm(ks[17], (N_C, d, 3 * d), d ** -0.5),
        "c_lam_q1": nrm(ks[18], (N_C, C_HEAD_DIM), 0.1),
        "c_lam_k1": nrm(ks[19], (N_C, C_HEAD_DIM), 0.1),
        "c_lam_q2": nrm(ks[20], (N_C, C_HEAD_DIM), 0.1),
        "c_lam_k2": nrm(ks[21], (N_C, C_HEAD_DIM), 0.1),
        "c_g_norm": 1.0 + nrm(ks[22], (N_C, 2 * C_HEAD_DIM), 0.02),
        "c_w_o": nrm(ks[23], (N_C, d, d), DN_BETA * d ** -0.5),
    }


def reference(x, ln1_g, ln1_b, ln2_g, ln2_b, ffn_w_gate_up, ffn_w_down, t5_table,
              a_w_qkv, a_rel_bias, a_w_o,
              b_w_in, b_w_g1, b_w_g2, b_b_g, b_g_norm, b_w_o,
              c_w_qkv, c_lam_q1, c_lam_k1, c_lam_q2, c_lam_k2, c_g_norm, c_w_o):
    h = x
    for i in range(DEPTH):
        kind = i % N_MIXERS
        j = i // N_MIXERS
        if kind == 0:
            y = chunk_band_attention(h, a_w_qkv[j], a_rel_bias[j], a_w_o[j])
        elif kind == 1:
            y = gated_linear_attention(h, b_w_in[j], b_w_g1[j], b_w_g2[j], b_b_g[j], b_g_norm[j], b_w_o[j])
        else:
            lambda_init = 0.8 - 0.6 * math.exp(-0.3 * i)
            y = differential_attention(h, c_w_qkv[j], c_lam_q1[j], c_lam_k1[j], c_lam_q2[j], c_lam_k2[j],
                                       c_g_norm[j], c_w_o[j], t5_table, lambda_init)
        h = layer_norm(DN_ALPHA * h + y, ln1_g[i], ln1_b[i])
        h = layer_norm(DN_ALPHA * h + swiglu(h, ffn_w_gate_up[i], ffn_w_down[i]), ln2_g[i], ln2_b[i])
    return h
```

```cpp
#include <hip/hip_runtime.h>
#include <cstdint>
#include <cstdio>
#include <cmath>

constexpr int D = 1024, BATCH = 8, SEQ = 2048, M = BATCH * SEQ, DEPTH = 4, CHUNK = 64, NCH = SEQ / CHUNK;
constexpr int FFN = 2816;
constexpr int A_HEADS = 16, A_LEFT = 8;
constexpr int B_HEADS = 4, B_KEY = 512, B_VAL = 1024, B_HK = 128, B_HV = 256, B_RANK = 16;
constexpr int C_HEADS = 8;
constexpr float LN_EPS = 1e-5f, RMS_EPS = 1e-6f;
constexpr float DN_ALPHA = 1.681792830507429f;

typedef float f32x4 __attribute__((ext_vector_type(4)));

__device__ __forceinline__ float wave_sum(float v) {
#pragma unroll
    for (int o = 1; o < 64; o <<= 1) v += __shfl_xor(v, o);
    return v;
}
#define WAVE_LDS_SYNC() asm volatile("s_waitcnt lgkmcnt(0)" ::: "memory")

struct EpiStore { float* C; int ldc; float scale;
    __device__ __forceinline__ void operator()(int row, int tile, int tx, const float (&a)[8]) const {
        float* p = C + (size_t)row * ldc + tile * 128 + tx * 4;
        *(f32x4*)p = (f32x4){a[0] * scale, a[1] * scale, a[2] * scale, a[3] * scale};
        *(f32x4*)(p + 64) = (f32x4){a[4] * scale, a[5] * scale, a[6] * scale, a[7] * scale};
    } };
struct EpiSwiglu { float* H; int ldh;
    __device__ __forceinline__ void operator()(int row, int tile, int tx, const float (&a)[8]) const {
        float o[4];
#pragma unroll
        for (int j = 0; j < 4; ++j) { const float g = a[j]; o[j] = g / (1.f + expf(-g)) * a[4 + j]; }
        *(f32x4*)(H + (size_t)row * ldh + tile * 64 + tx * 4) = (f32x4){o[0], o[1], o[2], o[3]};
    } };

template <class Epi, bool SWIGLU>
__global__ void __launch_bounds__(256) gemm_naive(const float* __restrict__ A, int lda, const float* __restrict__ W, int ldw, int K, Epi epi) {
    __shared__ float As[8][132];
    __shared__ float Bs[8][132];
    const int tid = threadIdx.x, tx = tid & 15, ty = tid >> 4;
    const int tile = blockIdx.x, rt = blockIdx.y;
    const int cg0 = SWIGLU ? tile * 64 : tile * 128, cu0 = SWIGLU ? FFN + tile * 64 : tile * 128 + 64;
    const int arow = tid >> 1, ak = (tid & 1) * 4;
    const int bk = tid >> 5, bv = (tid & 31) * 4;
    const int bcol = bv < 64 ? cg0 + bv : cu0 + bv - 64;
    const float* Ap = A + (size_t)(rt * 128 + arow) * lda + ak;
    const float* Wp = W + (size_t)bk * ldw + bcol;
    float acc[8][8];
#pragma unroll
    for (int i = 0; i < 8; ++i)
#pragma unroll
        for (int j = 0; j < 8; ++j) acc[i][j] = 0.f;
    for (int k0 = 0; k0 < K; k0 += 8) {
        const f32x4 av = *(const f32x4*)(Ap + k0);
        const f32x4 bvv = *(const f32x4*)(Wp + (size_t)k0 * ldw);
        __syncthreads();
        As[ak + 0][arow] = av[0]; As[ak + 1][arow] = av[1]; As[ak + 2][arow] = av[2]; As[ak + 3][arow] = av[3];
        *(f32x4*)&Bs[bk][bv] = bvv;
        __syncthreads();
#pragma unroll
        for (int k = 0; k < 8; ++k) {
            const f32x4 a0 = *(const f32x4*)&As[k][ty * 8], a1 = *(const f32x4*)&As[k][ty * 8 + 4];
            const f32x4 b0 = *(const f32x4*)&Bs[k][tx * 4], b1 = *(const f32x4*)&Bs[k][64 + tx * 4];
            const float a[8] = {a0[0], a0[1], a0[2], a0[3], a1[0], a1[1], a1[2], a1[3]};
            const float b[8] = {b0[0], b0[1], b0[2], b0[3], b1[0], b1[1], b1[2], b1[3]};
#pragma unroll
            for (int i = 0; i < 8; ++i)
#pragma unroll
                for (int j = 0; j < 8; ++j) acc[i][j] += a[i] * b[j];
        }
    }
#pragma unroll
    for (int i = 0; i < 8; ++i) epi(rt * 128 + ty * 8 + i, tile, tx, acc[i]);
}

__global__ void __launch_bounds__(256) ln_res_kernel(const float* hin, const float* y, const float* g, const float* b, float* hout) {
    const int lane = threadIdx.x & 63, row = blockIdx.x * 4 + (threadIdx.x >> 6);
    f32x4 v[4]; float s = 0.f;
#pragma unroll
    for (int j = 0; j < 4; ++j) { const size_t o = (size_t)row * D + j * 256 + lane * 4; v[j] = *(const f32x4*)(hin + o) * DN_ALPHA + *(const f32x4*)(y + o); s += (v[j][0] + v[j][1]) + (v[j][2] + v[j][3]); }
    const float mean = wave_sum(s) * (1.f / D); float q = 0.f;
#pragma unroll
    for (int j = 0; j < 4; ++j) { v[j] = v[j] - mean; q += (v[j][0] * v[j][0] + v[j][1] * v[j][1]) + (v[j][2] * v[j][2] + v[j][3] * v[j][3]); }
    const float rstd = 1.f / sqrtf(wave_sum(q) * (1.f / D) + LN_EPS);
#pragma unroll
    for (int j = 0; j < 4; ++j) { const int c = j * 256 + lane * 4; *(f32x4*)(hout + (size_t)row * D + c) = v[j] * rstd * *(const f32x4*)(g + c) + *(const f32x4*)(b + c); }
}

struct BiasA { const float* tab; int h;
    __device__ __forceinline__ float operator()(int qpos, int kpos) const { int rel = qpos - kpos; rel = rel < -128 ? -128 : (rel > 128 ? 128 : rel); return tab[(rel + 128) * A_HEADS + h]; } };
struct BiasC { const float* t5; int h;
    __device__ __forceinline__ float operator()(int qpos, int kpos) const {
        const int rel = kpos - qpos, n = rel < 0 ? -rel : rel; int v;
        if (n < 8) v = n; else { v = 2 + (31 - __clz(n * n)); v = v > 15 ? 15 : v; }
        return t5[((rel > 0 ? 16 : 0) + v) * C_HEADS + h]; } };

template <class Bias>
__device__ __forceinline__ void attn_wave(const float* Q, const float* Kp, const float* V, int ld, int q0, int k_lo, int k_hi, const Bias& bias, float* lds, int lane, float (&o)[64]) {
    float q[64];
    const int qpos = q0 + lane;
#pragma unroll
    for (int d = 0; d < 64; d += 4) { const f32x4 t = *(const f32x4*)(Q + (size_t)qpos * ld + d); q[d] = t[0] * 0.125f; q[d + 1] = t[1] * 0.125f; q[d + 2] = t[2] * 0.125f; q[d + 3] = t[3] * 0.125f; }
#pragma unroll
    for (int d = 0; d < 64; ++d) o[d] = 0.f;
    float m = -INFINITY, l = 0.f;
    float* Kt = lds; float* Vt = lds + 16 * 64;
    for (int kt = k_lo; kt < k_hi; kt += 16) {
        WAVE_LDS_SYNC();
#pragma unroll
        for (int i = 0; i < 4; ++i) { const int idx = lane + 64 * i, r = idx >> 4, c = (idx & 15) * 4;
            *(f32x4*)(Kt + r * 64 + c) = *(const f32x4*)(Kp + (size_t)(kt + r) * ld + c);
            *(f32x4*)(Vt + r * 64 + c) = *(const f32x4*)(V + (size_t)(kt + r) * ld + c); }
        WAVE_LDS_SYNC();
        float s[16]; float tm = -INFINITY;
#pragma unroll
        for (int j = 0; j < 16; ++j) { float a = 0.f;
#pragma unroll
            for (int d = 0; d < 64; d += 4) { const f32x4 kv = *(const f32x4*)(Kt + j * 64 + d); a += q[d] * kv[0] + q[d + 1] * kv[1] + q[d + 2] * kv[2] + q[d + 3] * kv[3]; }
            a += bias(qpos, kt + j); s[j] = a; tm = fmaxf(tm, a); }
        const float mn = fmaxf(m, tm), al = expf(m - mn); m = mn; l *= al;
#pragma unroll
        for (int d = 0; d < 64; ++d) o[d] *= al;
#pragma unroll
        for (int j = 0; j < 16; ++j) { const float p = expf(s[j] - mn); l += p;
#pragma unroll
            for (int d = 0; d < 64; d += 4) { const f32x4 vv = *(const f32x4*)(Vt + j * 64 + d); o[d] += p * vv[0]; o[d + 1] += p * vv[1]; o[d + 2] += p * vv[2]; o[d + 3] += p * vv[3]; } }
    }
    const float rl = 1.f / l;
#pragma unroll
    for (int d = 0; d < 64; ++d) o[d] *= rl;
}

__global__ void __launch_bounds__(256) attnA_kernel(const float* qkv, const float* relb, float* out) {
    __shared__ __attribute__((aligned(16))) float lds[4 * 2048];
    const int lane = threadIdx.x & 63, w = threadIdx.x >> 6; const int unit = blockIdx.x * 4 + w;
    const int h = unit % A_HEADS, c = (unit / A_HEADS) % NCH, b = unit / (A_HEADS * NCH);
    const float* base = qkv + (size_t)b * SEQ * 3072;
    BiasA bias{relb, h};
    float o[64];
    const int klo = (c - A_LEFT) * CHUNK < 0 ? 0 : (c - A_LEFT) * CHUNK;
    attn_wave(base + h * 64, base + 1024 + h * 64, base + 2048 + h * 64, 3072, c * CHUNK, klo, (c + 1) * CHUNK, bias, lds + w * 2048, lane, o);
    float* op = out + ((size_t)b * SEQ + c * CHUNK + lane) * D + h * 64;
#pragma unroll
    for (int d = 0; d < 64; d += 4) *(f32x4*)(op + d) = (f32x4){o[d], o[d + 1], o[d + 2], o[d + 3]};
}

__global__ void __launch_bounds__(256) attnC_kernel(const float* qkv, const float* t5, const float* lq1, const float* lk1, const float* lq2, const float* lk2, float lambda_init, float* out) {
    __shared__ __attribute__((aligned(16))) float lds[4 * 2048];
    const int lane = threadIdx.x & 63, w = threadIdx.x >> 6; const int unit = blockIdx.x * 4 + w;
    const int vh = unit & 1, h = (unit >> 1) % C_HEADS, c = (unit / (2 * C_HEADS)) % NCH, b = unit / (2 * C_HEADS * NCH);
    const float lam = expf(wave_sum(lq1[lane] * lk1[lane])) - expf(wave_sum(lq2[lane] * lk2[lane])) + lambda_init;
    const float* base = qkv + (size_t)b * SEQ * 3072;
    BiasC bias{t5, h};
    float o1[64];
    float* op = out + ((size_t)b * SEQ + c * CHUNK + lane) * D + h * 128 + vh * 64;
    attn_wave(base + h * 128, base + 1024 + h * 128, base + 2048 + h * 128 + vh * 64, 3072, c * CHUNK, 0, (c + 1) * CHUNK, bias, lds + w * 2048, lane, o1);
#pragma unroll
    for (int d = 0; d < 64; d += 4) *(f32x4*)(op + d) = (f32x4){o1[d], o1[d + 1], o1[d + 2], o1[d + 3]};
    attn_wave(base + h * 128 + 64, base + 1024 + h * 128 + 64, base + 2048 + h * 128 + vh * 64, 3072, c * CHUNK, 0, (c + 1) * CHUNK, bias, lds + w * 2048, lane, o1);
#pragma unroll
    for (int d = 0; d < 64; d += 4) { const f32x4 a = *(f32x4*)(op + d); *(f32x4*)(op + d) = (f32x4){a[0] - lam * o1[d], a[1] - lam * o1[d + 1], a[2] - lam * o1[d + 2], a[3] - lam * o1[d + 3]}; }
}
__global__ void __launch_bounds__(256) normC_kernel(float* x, const float* g, float lambda_init) {
    const int lane = threadIdx.x & 63, row = blockIdx.x * 4 + (threadIdx.x >> 6);
#pragma unroll
    for (int j = 0; j < 4; ++j) { float* p = x + (size_t)row * D + j * 256 + lane * 4; f32x4 v = *(f32x4*)p;
        float s = (v[0] * v[0] + v[1] * v[1]) + (v[2] * v[2] + v[3] * v[3]);
#pragma unroll
        for (int o = 1; o < 32; o <<= 1) s += __shfl_xor(s, o);
        const float r = 1.f / sqrtf(s * (1.f / 128.f) + RMS_EPS) * (1.f - lambda_init);
        const f32x4 gv = *(const f32x4*)(g + ((lane * 4) & 127));
        *(f32x4*)p = v * r * gv; }
}

__global__ void __launch_bounds__(256) gla_xg_kernel(const float* h, const float* wg1, float* xg) {
    const int lane = threadIdx.x & 63, row = blockIdx.x * 4 + (threadIdx.x >> 6);
    float a[16];
#pragma unroll
    for (int r = 0; r < 16; ++r) a[r] = 0.f;
    for (int i = 0; i < 16; ++i) { const int k = i * 64 + lane; const float x = h[(size_t)row * D + k];
#pragma unroll
        for (int r = 0; r < 16; r += 4) { const f32x4 wv = *(const f32x4*)(wg1 + (size_t)k * 16 + r); a[r] += x * wv[0]; a[r + 1] += x * wv[1]; a[r + 2] += x * wv[2]; a[r + 3] += x * wv[3]; } }
#pragma unroll
    for (int r = 0; r < 16; ++r) a[r] = wave_sum(a[r]);
    if (lane < 16) { float v = a[0];
#pragma unroll
        for (int r = 1; r < 16; ++r) v = lane == r ? a[r] : v;
        xg[(size_t)row * 16 + lane] = v; }
}
__device__ __forceinline__ float logsigmoidf(float z) { return fminf(z, 0.f) - log1pf(expf(-fabsf(z))); }
__global__ void __launch_bounds__(256) gla_prep_kernel(float* qkv, const float* xg, const float* wg2, const float* bg, float* decay) {
    const int gid = blockIdx.x * 256 + threadIdx.x, c = gid & 511, bn = gid >> 9;
    float w[16];
#pragma unroll
    for (int r = 0; r < 16; ++r) w[r] = wg2[r * 512 + c];
    const float bias = bg[c]; const size_t row0 = (size_t)bn * CHUNK;
    float total = 0.f;
    for (int p = 0; p < 64; ++p) { float z = bias; const float* xr = xg + (row0 + p) * 16;
#pragma unroll
        for (int r = 0; r < 16; ++r) z += xr[r] * w[r];
        total += logsigmoidf(z) * (1.f / 16.f); }
    float cum = 0.f;
    for (int p = 0; p < 64; ++p) { float z = bias; const float* xr = xg + (row0 + p) * 16;
#pragma unroll
        for (int r = 0; r < 16; ++r) z += xr[r] * w[r];
        cum += logsigmoidf(z) * (1.f / 16.f);
        float* kp = qkv + (row0 + p) * 3072 + 512 + c; *kp = *kp * expf(total - cum); }
    decay[(size_t)bn * 512 + c] = expf(total);
}
__global__ void __launch_bounds__(64) gla_scan_kernel(const float* qkv, const float* decay, float* o) {
    __shared__ __attribute__((aligned(16))) float lds[16 * 128];
    const int lane = threadIdx.x, unit = blockIdx.x, vs = unit & 3, h = (unit >> 2) & 3, b = unit >> 4;
    float st[128];
#pragma unroll
    for (int k = 0; k < 128; ++k) st[k] = 0.f;
    const float qs = 0.08838834764831845f;
    for (int n = 0; n < NCH; ++n) {
        const size_t row0 = (size_t)b * SEQ + n * CHUNK;
        const float* dp = decay + ((size_t)b * NCH + n) * 512 + h * 128;
#pragma unroll
        for (int k = 0; k < 128; k += 4) { const f32x4 dv = *(const f32x4*)(dp + k); st[k] *= dv[0]; st[k + 1] *= dv[1]; st[k + 2] *= dv[2]; st[k + 3] *= dv[3]; }
        for (int sub = 0; sub < 4; ++sub) {
            WAVE_LDS_SYNC();
#pragma unroll
            for (int i = 0; i < 8; ++i) { const int idx = lane + 64 * i, r = idx >> 5, cc = (idx & 31) * 4;
                *(f32x4*)(lds + r * 128 + cc) = *(const f32x4*)(qkv + (row0 + sub * 16 + r) * 3072 + 512 + h * 128 + cc); }
            WAVE_LDS_SYNC();
            for (int p = 0; p < 16; ++p) { const float vv = qkv[(row0 + sub * 16 + p) * 3072 + 1024 + h * 256 + vs * 64 + lane];
#pragma unroll
                for (int k = 0; k < 128; k += 4) { const f32x4 kv = *(const f32x4*)(lds + p * 128 + k); st[k] += kv[0] * vv; st[k + 1] += kv[1] * vv; st[k + 2] += kv[2] * vv; st[k + 3] += kv[3] * vv; } }
        }
        for (int sub = 0; sub < 4; ++sub) {
            WAVE_LDS_SYNC();
#pragma unroll
            for (int i = 0; i < 8; ++i) { const int idx = lane + 64 * i, r = idx >> 5, cc = (idx & 31) * 4;
                *(f32x4*)(lds + r * 128 + cc) = *(const f32x4*)(qkv + (row0 + sub * 16 + r) * 3072 + h * 128 + cc); }
            WAVE_LDS_SYNC();
            for (int p = 0; p < 16; ++p) { float a = 0.f;
#pragma unroll
                for (int k = 0; k < 128; k += 4) { const f32x4 qv = *(const f32x4*)(lds + p * 128 + k); a += qv[0] * st[k] + qv[1] * st[k + 1] + qv[2] * st[k + 2] + qv[3] * st[k + 3]; }
                o[(row0 + sub * 16 + p) * D + h * 256 + vs * 64 + lane] = a * qs; }
        }
    }
}
__global__ void __launch_bounds__(256) gla_norm_kernel(float* o, const float* qkv, const float* g) {
    const int lane = threadIdx.x & 63, row = blockIdx.x * 4 + (threadIdx.x >> 6);
#pragma unroll
    for (int j = 0; j < 4; ++j) { float* p = o + (size_t)row * D + j * 256 + lane * 4; const f32x4 v = *(f32x4*)p;
        const float s = wave_sum((v[0] * v[0] + v[1] * v[1]) + (v[2] * v[2] + v[3] * v[3]));
        const float r = 1.f / sqrtf(s * (1.f / 256.f) + RMS_EPS);
        const f32x4 gv = *(const f32x4*)(g + lane * 4), rv = *(const f32x4*)(qkv + (size_t)row * 3072 + 2048 + j * 256 + lane * 4);
        f32x4 out;
#pragma unroll
        for (int e = 0; e < 4; ++e) out[e] = v[e] * r * gv[e] * (rv[e] / (1.f + expf(-rv[e])));
        *(f32x4*)p = out; }
}

extern "C" void kernel_launch(void* const* d_in, const int* in_sizes, int n_in, void* d_out, int out_size, void* d_ws, size_t ws_size, hipStream_t stream) {
    constexpr size_t MiB = 1u << 20;
    if (n_in != 24 || in_sizes[0] != M * D || out_size != M * D || ws_size < 324 * MiB) { fprintf(stderr, "kernel_launch: unexpected shapes (n_in %d, ws %zu)\n", n_in, ws_size); return; }
    const float* x = (const float*)d_in[0];
    const float *ln1_g = (const float*)d_in[1], *ln1_b = (const float*)d_in[2], *ln2_g = (const float*)d_in[3], *ln2_b = (const float*)d_in[4];
    const float *w_gu = (const float*)d_in[5], *w_dn = (const float*)d_in[6], *t5 = (const float*)d_in[7];
    const float *a_wqkv = (const float*)d_in[8], *a_relb = (const float*)d_in[9], *a_wo = (const float*)d_in[10];
    const float *b_win = (const float*)d_in[11], *b_wg1 = (const float*)d_in[12], *b_wg2 = (const float*)d_in[13], *b_bg = (const float*)d_in[14], *b_gn = (const float*)d_in[15], *b_wo = (const float*)d_in[16];
    const float *c_wqkv = (const float*)d_in[17], *c_lq1 = (const float*)d_in[18], *c_lk1 = (const float*)d_in[19], *c_lq2 = (const float*)d_in[20], *c_lk2 = (const float*)d_in[21], *c_gn = (const float*)d_in[22], *c_wo = (const float*)d_in[23];
    char* ws = (char*)d_ws;
    float* H = (float*)(ws);
    float* QKV = (float*)(ws + 64 * MiB);
    float* ATT = (float*)(ws + 256 * MiB);
    float* XG = (float*)(ws + 320 * MiB);
    float* DEC = (float*)(ws + 322 * MiB);
    const float* hin = x;
    for (int i = 0; i < DEPTH; ++i) {
        const int kind = i % 3, j = i / 3;
        const float* wo;
        if (kind == 0) {
            gemm_naive<EpiStore, false><<<dim3(24, 128), 256, 0, stream>>>(hin, D, a_wqkv + (size_t)j * D * 3072, 3072, D, EpiStore{QKV, 3072, 1.f});
            attnA_kernel<<<BATCH * NCH * A_HEADS / 4, 256, 0, stream>>>(QKV, a_relb + (size_t)j * 257 * A_HEADS, ATT);
            wo = a_wo + (size_t)j * D * D;
        } else if (kind == 1) {
            gemm_naive<EpiStore, false><<<dim3(24, 128), 256, 0, stream>>>(hin, D, b_win + (size_t)j * D * 3072, 3072, D, EpiStore{QKV, 3072, 1.f});
            gla_xg_kernel<<<M / 4, 256, 0, stream>>>(hin, b_wg1 + (size_t)j * D * 16, XG);
            gla_prep_kernel<<<BATCH * NCH * 512 / 256, 256, 0, stream>>>(QKV, XG, b_wg2 + (size_t)j * 16 * 512, b_bg + (size_t)j * 512, DEC);
            gla_scan_kernel<<<BATCH * B_HEADS * 4, 64, 0, stream>>>(QKV, DEC, ATT);
            gla_norm_kernel<<<M / 4, 256, 0, stream>>>(ATT, QKV, b_gn + (size_t)j * B_HV);
            wo = b_wo + (size_t)j * D * D;
        } else {
            const float lambda_init = (float)(0.8 - 0.6 * exp(-0.3 * (double)i));
            gemm_naive<EpiStore, false><<<dim3(24, 128), 256, 0, stream>>>(hin, D, c_wqkv + (size_t)j * D * 3072, 3072, D, EpiStore{QKV, 3072, 1.f});
            attnC_kernel<<<BATCH * NCH * C_HEADS * 2 / 4, 256, 0, stream>>>(QKV, t5, c_lq1 + j * 64, c_lk1 + j * 64, c_lq2 + j * 64, c_lk2 + j * 64, lambda_init, ATT);
            normC_kernel<<<M / 4, 256, 0, stream>>>(ATT, c_gn + (size_t)j * 128, lambda_init);
            wo = c_wo + (size_t)j * D * D;
        }
        float* Y = QKV;
        gemm_naive<EpiStore, false><<<dim3(8, 128), 256, 0, stream>>>(ATT, D, wo, D, D, EpiStore{Y, D, 1.f});
        ln_res_kernel<<<M / 4, 256, 0, stream>>>(hin, Y, ln1_g + i * D, ln1_b + i * D, H);
        float* HID = QKV;
        gemm_naive<EpiSwiglu, true><<<dim3(FFN / 64, 128), 256, 0, stream>>>(H, D, w_gu + (size_t)i * D * 2 * FFN, 2 * FFN, D, EpiSwiglu{HID, FFN});
        gemm_naive<EpiStore, false><<<dim3(8, 128), 256, 0, stream>>>(HID, FFN, w_dn + (size_t)i * FFN * D, D, FFN, EpiStore{ATT, D, 1.f});
        ln_res_kernel<<<M / 4, 256, 0, stream>>>(H, ATT, ln2_g + i * D, ln2_b + i * D, i == DEPTH - 1 ? (float*)d_out : H);
        hin = H;
    }
}
```
